# Optimizing an MI355X kernel written in HIP

```python
import jax, jax.numpy as jnp
from jax import lax
import numpy as np

D_MODEL = 1024
BATCH = 4
SEQ = 4096
DEPTH = 1

CHUNK = 64

MIX_WIDTH = D_MODEL
CONV_WIDTH = MIX_WIDTH // 2
CONV_HEADS = 8
CONV_K = 3
POOL_WIDTH = MIX_WIDTH - CONV_WIDTH
POOL_WINDOWS = (2, 4, 8, 16)
POOL_GROUPS = len(POOL_WINDOWS)
POOL_GW = POOL_WIDTH // POOL_GROUPS
IN_PROJ = 3 * CONV_WIDTH + POOL_WIDTH

N_GROUPS = 4
EXPERTS_PER_GROUP = 8
TOP_K_EXPERTS = 2
D_EXPERT = D_MODEL // 4

PLE_DIM = 256
LN_EPS = 1e-5
DEEPNORM_ALPHA = (2.0 * DEPTH) ** 0.25
DEEPNORM_BETA = (8.0 * DEPTH) ** -0.25

kernel_name = "hybrid_conv_pool_hmoe_deepnorm_block"


def _layernorm(x, g, b):
    xf = x.astype(jnp.float32)
    mu = jnp.mean(xf, axis=-1, keepdims=True)
    var = jnp.mean(jnp.square(xf - mu), axis=-1, keepdims=True)
    y = (xf - mu) * lax.rsqrt(var + LN_EPS) * g.astype(jnp.float32) + b.astype(jnp.float32)
    return y.astype(x.dtype)


def _token_mixers(h, w_in, conv_w, conv_b, pool_w, pool_scale, w_out):
    bsz, seq, _ = h.shape
    u = h @ w_in
    b_g, c_g, v_c, v_p = jnp.split(u, [CONV_WIDTH, 2 * CONV_WIDTH, 3 * CONV_WIDTH], axis=-1)

    z = c_g * v_c
    zp = jnp.pad(z, ((0, 0), (CONV_K - 1, 0), (0, 0)))
    conv = sum(zp[:, k:k + seq] * conv_w[k] for k in range(CONV_K)) + conv_b
    y_conv = b_g * conv

    vp = v_p.reshape(bsz, seq, POOL_GROUPS, POOL_GW)
    cs0 = jnp.pad(jnp.cumsum(vp.astype(jnp.float32), axis=1), ((0, 0), (1, 0), (0, 0), (0, 0)))
    t = jnp.arange(seq)
    means = []
    for j, w in enumerate(POOL_WINDOWS):
        c = jnp.pad(cs0[:, :, j], ((0, 0), (w - 1, 0), (0, 0)))
        wsum = c[:, w:w + seq] - c[:, :seq]
        cnt = jnp.minimum(t + 1, w).astype(jnp.float32)[None, :, None]
        means.append(wsum / cnt)
    pooled = jnp.stack(means, axis=2).astype(h.dtype) - vp
    y_pool = jnp.einsum('bsgc,gcd->bsgd', pooled, pool_w).reshape(bsz, seq, POOL_WIDTH) * pool_scale

    return jnp.concatenate([y_conv, y_pool], axis=-1) @ w_out


def _hier_moe(h, w_rg, b_rg, w_re, b_re, w_gate, w_up, w_down):
    bsz, seq, d = h.shape
    tok = h.reshape(-1, d)
    g_logits = (tok @ w_rg).astype(jnp.float32) + b_rg.astype(jnp.float32)
    g_prob = jax.nn.softmax(g_logits, axis=-1)
    g_val, g_idx = lax.top_k(g_logits, 1)
    g_idx = g_idx[:, 0]
    g_w = jnp.take_along_axis(g_prob, g_idx[:, None], axis=-1)[:, 0]
    e_all = jnp.einsum('td,gde->tge', tok, w_re).astype(jnp.float32) + b_re.astype(jnp.float32)
    e_logits = jnp.take_along_axis(e_all, g_idx[:, None, None], axis=1)[:, 0]
    top_v, top_i = lax.top_k(e_logits, TOP_K_EXPERTS)
    top_w = jax.nn.softmax(top_v, axis=-1) * g_w[:, None]
    exp_w = jnp.sum(jax.nn.one_hot(top_i, EXPERTS_PER_GROUP, dtype=jnp.float32) * top_w[..., None], axis=1)
    combine = jax.nn.one_hot(g_idx, N_GROUPS, dtype=jnp.float32)[:, :, None] * exp_w[:, None, :]
    combine = combine.astype(h.dtype)
    out = jnp.zeros_like(tok)
    for g in range(N_GROUPS):
        hg = jnp.einsum('td,edf->tef', tok, w_gate[g])
        hu = jnp.einsum('td,edf->tef', tok, w_up[g])
        act = jax.nn.silu(hg) * hu * combine[:, g, :, None]
        out = out + jnp.einsum('tef,efd->td', act, w_down[g])
    return out.reshape(bsz, seq, d)


def setup_inputs(seed: int = 0) -> dict:
    key = jax.random.key(seed)
    ks = jax.random.split(key, 26)
    f32 = jnp.float32
    nrm = lambda k, shape, s: (jax.random.normal(k, shape, f32) * s)
    E = EXPERTS_PER_GROUP
    return {
        "x": nrm(ks[0], (BATCH, SEQ, D_MODEL), 1.0),
        "p": nrm(ks[1], (DEPTH, BATCH, SEQ, PLE_DIM), 1.0),
        "ln_in_g": 1.0 + nrm(ks[2], (D_MODEL,), 0.02),
        "ln_in_b": nrm(ks[3], (D_MODEL,), 0.02),
        "w_in": nrm(ks[4], (DEPTH, D_MODEL, IN_PROJ), D_MODEL ** -0.5),
        "conv_w": nrm(ks[5], (DEPTH, CONV_K, CONV_WIDTH), CONV_K ** -0.5),
        "conv_b": nrm(ks[6], (DEPTH, CONV_WIDTH), 0.02),
        "pool_w": nrm(ks[7], (DEPTH, POOL_GROUPS, POOL_GW, POOL_GW), POOL_GW ** -0.5),
        "pool_scale": 1.0 + nrm(ks[8], (DEPTH, POOL_WIDTH), 0.02),
        "w_out": nrm(ks[9], (DEPTH, MIX_WIDTH, D_MODEL), MIX_WIDTH ** -0.5 * DEEPNORM_BETA),
        "ln1_g": 1.0 + nrm(ks[10], (DEPTH, D_MODEL), 0.02),
        "ln1_b": nrm(ks[11], (DEPTH, D_MODEL), 0.02),
        "w_rg": nrm(ks[12], (DEPTH, D_MODEL, N_GROUPS), D_MODEL ** -0.5),
        "b_rg": nrm(ks[13], (DEPTH, N_GROUPS), 0.01),
        "w_re": nrm(ks[14], (DEPTH, N_GROUPS, D_MODEL, E), D_MODEL ** -0.5),
        "b_re": nrm(ks[15], (DEPTH, N_GROUPS, E), 0.01),
        "w_gate": nrm(ks[16], (DEPTH, N_GROUPS, E, D_MODEL, D_EXPERT), D_MODEL ** -0.5),
        "w_up": nrm(ks[17], (DEPTH, N_GROUPS, E, D_MODEL, D_EXPERT), D_MODEL ** -0.5),
        "w_down": nrm(ks[18], (DEPTH, N_GROUPS, E, D_EXPERT, D_MODEL), D_EXPERT ** -0.5 * DEEPNORM_BETA),
        "w_pg": nrm(ks[19], (DEPTH, D_MODEL, D_MODEL), D_MODEL ** -0.5),
        "b_pg": nrm(ks[20], (DEPTH, D_MODEL), 0.02),
        "w_ple": nrm(ks[21], (DEPTH, PLE_DIM, D_MODEL), PLE_DIM ** -0.5 * DEEPNORM_BETA),
        "ln2_g": 1.0 + nrm(ks[22], (DEPTH, D_MODEL), 0.02),
        "ln2_b": nrm(ks[23], (DEPTH, D_MODEL), 0.02),
    }


def reference(x, p, ln_in_g, ln_in_b, w_in, conv_w, conv_b, pool_w, pool_scale, w_out, ln1_g, ln1_b,
              w_rg, b_rg, w_re, b_re, w_gate, w_up, w_down, w_pg, b_pg, w_ple, ln2_g, ln2_b):
    h = _layernorm(x, ln_in_g, ln_in_b)
    for i in range(DEPTH):
        mix = _token_mixers(h, w_in[i], conv_w[i], conv_b[i], pool_w[i], pool_scale[i], w_out[i])
        h = _layernorm(DEEPNORM_ALPHA * h + mix, ln1_g[i], ln1_b[i])
        moe = _hier_moe(h, w_rg[i], b_rg[i], w_re[i], b_re[i], w_gate[i], w_up[i], w_down[i])
        ple = (p[i] @ w_ple[i]) * jax.nn.sigmoid(h @ w_pg[i] + b_pg[i])
        h = _layernorm(DEEPNORM_ALPHA * h + moe + ple, ln2_g[i], ln2_b[i])
    return h
```

```cpp
#include <hip/hip_runtime.h>
#include <stdint.h>

constexpr int D = 1024, BATCH = 4, SEQ = 4096, M = BATCH * SEQ;
constexpr int CW = 512, INP = 2048, PLE = 256, NGRP = 4, NEXP = 8, NE = NGRP * NEXP, DE = 256;
constexpr float LN_EPS = 1e-5f;
constexpr float ALPHA = 1.189207115002721f;

typedef unsigned short bf16_t;
__device__ __forceinline__ unsigned f2bf(float f) { unsigned u = __float_as_uint(f); return (u + 0x7fffu + ((u >> 16) & 1u)) >> 16; }
__device__ __forceinline__ float bf2f(unsigned h) { return __uint_as_float(h << 16); }
__device__ __forceinline__ float wave_sum(float v) {
#pragma unroll
    for (int o = 1; o < 64; o <<= 1) v += __shfl_xor(v, o);
    return v;
}

constexpr size_t MiB = 1u << 20;
constexpr size_t WS_CTL = 0;
constexpr size_t WS_LIST = 1 * MiB;
constexpr size_t WS_LISTW = 3 * MiB;
constexpr size_t WS_TOKEP = 5 * MiB;
constexpr size_t WS_W2F = 6 * MiB;
constexpr size_t WS_H0 = 10 * MiB;
constexpr size_t WS_Y = 42 * MiB;
constexpr size_t WS_H1 = 74 * MiB;
constexpr size_t WS_PB = 106 * MiB;
constexpr size_t WS_PP = 114 * MiB;
constexpr size_t WS_MOE = 146 * MiB;
constexpr int CW_CNT = 64, CW_BASE = 128;

template <bool OUT_BF16>
__global__ void __launch_bounds__(256) k_ln(const float* in, const float* g, const float* b, void* out, int rows) {
    const int wave = (blockIdx.x * 256 + threadIdx.x) >> 6, lane = threadIdx.x & 63;
    if (wave >= rows) return;
    const float4* xr = (const float4*)(in + (size_t)wave * D) + lane;
    float4 v[4]; float s = 0.f;
#pragma unroll
    for (int j = 0; j < 4; ++j) { v[j] = xr[64 * j]; s += (v[j].x + v[j].y) + (v[j].z + v[j].w); }
    const float mean = wave_sum(s) * (1.f / D); float s2 = 0.f;
#pragma unroll
    for (int j = 0; j < 4; ++j) { v[j].x -= mean; v[j].y -= mean; v[j].z -= mean; v[j].w -= mean; s2 += (v[j].x * v[j].x + v[j].y * v[j].y) + (v[j].z * v[j].z + v[j].w * v[j].w); }
    const float rstd = 1.f / sqrtf(wave_sum(s2) * (1.f / D) + LN_EPS);
#pragma unroll
    for (int j = 0; j < 4; ++j) {
        const float4 gg = ((const float4*)g)[lane + 64 * j], bb = ((const float4*)b)[lane + 64 * j];
        float4 o; o.x = v[j].x * rstd * gg.x + bb.x; o.y = v[j].y * rstd * gg.y + bb.y; o.z = v[j].z * rstd * gg.z + bb.z; o.w = v[j].w * rstd * gg.w + bb.w;
        if (OUT_BF16) { uint2 w; w.x = f2bf(o.x) | (f2bf(o.y) << 16); w.y = f2bf(o.z) | (f2bf(o.w) << 16); ((uint2*)((bf16_t*)out + (size_t)wave * D))[lane + 64 * j] = w; }
        else ((float4*)((float*)out + (size_t)wave * D))[lane + 64 * j] = o;
    }
}

__global__ void __launch_bounds__(256) k_cvt(const float* in, bf16_t* out, int n4) {
    const int i = blockIdx.x * 256 + threadIdx.x; if (i >= n4) return;
    const float4 v = ((const float4*)in)[i]; uint2 w; w.x = f2bf(v.x) | (f2bf(v.y) << 16); w.y = f2bf(v.z) | (f2bf(v.w) << 16); ((uint2*)out)[i] = w;
}

template <class Epi>
__global__ void __launch_bounds__(256) k_gemm_naive(const bf16_t* A, int lda, const float* B, int N, int K, Epi epi) {
    __shared__ float As[16][68]; __shared__ float Bs[16][64];
    const int t = threadIdx.x, tx = t & 15, ty = t >> 4, r0 = blockIdx.y * 64, j0 = blockIdx.x * 16, N4 = N / 4;
    float acc[4][4];
#pragma unroll
    for (int i = 0; i < 4; ++i)
#pragma unroll
        for (int s = 0; s < 4; ++s) acc[i][s] = 0.f;
    for (int k0 = 0; k0 < K; k0 += 16) {
        { const int row = t >> 2, k4 = (t & 3) * 4; const uint2 raw = *(const uint2*)(A + (size_t)(r0 + row) * lda + k0 + k4);
          As[k4 + 0][row] = bf2f(raw.x & 0xffffu); As[k4 + 1][row] = bf2f(raw.x >> 16); As[k4 + 2][row] = bf2f(raw.y & 0xffffu); As[k4 + 3][row] = bf2f(raw.y >> 16); }
        { const int k = t >> 4, c4 = (t & 15) * 4, s = c4 >> 4, w = c4 & 15;
          *(float4*)&Bs[k][c4] = *(const float4*)(B + (size_t)(k0 + k) * N + s * N4 + j0 + w); }
        __syncthreads();
#pragma unroll
        for (int k = 0; k < 16; ++k) {
            const float4 a = *(const float4*)&As[k][ty * 4]; const float bq[4] = {Bs[k][tx], Bs[k][16 + tx], Bs[k][32 + tx], Bs[k][48 + tx]}; const float aq[4] = {a.x, a.y, a.z, a.w};
#pragma unroll
            for (int i = 0; i < 4; ++i)
#pragma unroll
                for (int s = 0; s < 4; ++s) acc[i][s] += aq[i] * bq[s];
        }
        __syncthreads();
    }
#pragma unroll
    for (int i = 0; i < 4; ++i) epi(r0 + ty * 4 + i, j0 + tx, acc[i][0], acc[i][1], acc[i][2], acc[i][3]);
}

struct EpiU2 {
    bf16_t* U2;
    __device__ void operator()(int row, int j, float bg, float cg, float vc, float vp) const {
        bf16_t* r = U2 + (size_t)row * 1536; r[j] = (bf16_t)f2bf(cg * vc); r[512 + j] = (bf16_t)f2bf(bg); r[1024 + j] = (bf16_t)f2bf(vp);
    }
};
struct EpiR1 {
    const bf16_t* H0; float* R1;
    __device__ void operator()(int row, int j, float v0, float v1, float v2, float v3) const {
        const float v[4] = {v0, v1, v2, v3};
#pragma unroll
        for (int s = 0; s < 4; ++s) { const size_t o = (size_t)row * D + s * 256 + j; R1[o] = ALPHA * bf2f(H0[o]) + v[s]; }
    }
};
struct EpiPP {
    bf16_t* PP;
    __device__ void operator()(int row, int j, float v0, float v1, float v2, float v3) const {
        const float v[4] = {v0, v1, v2, v3};
#pragma unroll
        for (int s = 0; s < 4; ++s) PP[(size_t)row * D + s * 256 + j] = (bf16_t)f2bf(v[s]);
    }
};
struct EpiR2 {
    const bf16_t* H1; const bf16_t* PP; const bf16_t* MOE; const unsigned* tokep; const unsigned* base; const float* bpg; float* out;
    __device__ void operator()(int row, int j, float v0, float v1, float v2, float v3) const {
        const float v[4] = {v0, v1, v2, v3};
        const unsigned ep0 = tokep[2 * row], ep1 = tokep[2 * row + 1];
        const size_t m0 = (size_t)(base[ep0 >> 24] + (ep0 & 0xffffffu)) * D, m1 = (size_t)(base[ep1 >> 24] + (ep1 & 0xffffffu)) * D;
#pragma unroll
        for (int s = 0; s < 4; ++s) { const int c = s * 256 + j; const size_t o = (size_t)row * D + c;
            const float gate = v[s] + bpg[c], sig = 1.f / (1.f + __expf(-gate));
            out[o] = ALPHA * bf2f(H1[o]) + bf2f(MOE[m0 + c]) + bf2f(MOE[m1 + c]) + bf2f(PP[o]) * sig; }
    }
};

__global__ void __launch_bounds__(256) k_stencil(const bf16_t* U2, const float* conv_w, const float* conv_b, bf16_t* Y) {
    const int idx = blockIdx.x * 256 + threadIdx.x, row = idx >> 9, j = idx & 511, tp = row & (SEQ - 1);
    const bf16_t* u = U2 + (size_t)row * 1536;
    const float z0 = bf2f(u[j]), z1 = tp >= 1 ? bf2f(u[j - 1536]) : 0.f, z2 = tp >= 2 ? bf2f(u[j - 2 * 1536]) : 0.f;
    const float conv = z2 * conv_w[j] + z1 * conv_w[512 + j] + z0 * conv_w[1024 + j] + conv_b[j];
    Y[(size_t)row * D + j] = (bf16_t)f2bf(bf2f(u[512 + j]) * conv);
    const int g = j >> 7, w = 2 << g, n = (tp + 1 < w) ? tp + 1 : w;
    float sum = 0.f;
    for (int s = 0; s < n; ++s) sum += bf2f(u[1024 + j - s * 1536]);
    Y[(size_t)row * D + 512 + j] = (bf16_t)f2bf(sum / (float)n - bf2f(u[1024 + j]));
}

__global__ void __launch_bounds__(256) k_w2(const float* w_out, const float* pool_w, const float* pool_scale, float* W2F) {
    const int idx = blockIdx.x * 256 + threadIdx.x, k = idx >> 10, n = idx & 1023;
    if (k < 512) { W2F[idx] = w_out[idx]; return; }
    const int g = (k - 512) >> 7, c = (k - 512) & 127; float s = 0.f;
    for (int d = 0; d < 128; ++d) s += pool_w[(g * 128 + c) * 128 + d] * pool_scale[g * 128 + d] * w_out[(size_t)(512 + g * 128 + d) * D + n];
    W2F[idx] = s;
}

__global__ void __launch_bounds__(256) k_router(const bf16_t* H1, const float* w_rg, const float* b_rg, const float* w_re, const float* b_re,
                                                unsigned* cnt, unsigned* list, float* listw, unsigned* tokep) {
    const int t = (blockIdx.x * 256 + threadIdx.x) >> 6, lane = threadIdx.x & 63;
    float lg[4] = {0.f, 0.f, 0.f, 0.f}, le[4][8];
#pragma unroll
    for (int g = 0; g < 4; ++g)
#pragma unroll
        for (int e = 0; e < 8; ++e) le[g][e] = 0.f;
    for (int k = lane; k < D; k += 64) {
        const float h = bf2f(H1[(size_t)t * D + k]);
        const float4 wg = *(const float4*)(w_rg + k * 4);
        lg[0] += h * wg.x; lg[1] += h * wg.y; lg[2] += h * wg.z; lg[3] += h * wg.w;
#pragma unroll
        for (int g = 0; g < 4; ++g) { const float4 a = *(const float4*)(w_re + ((size_t)g * D + k) * 8), b = *(const float4*)(w_re + ((size_t)g * D + k) * 8 + 4);
            le[g][0] += h * a.x; le[g][1] += h * a.y; le[g][2] += h * a.z; le[g][3] += h * a.w; le[g][4] += h * b.x; le[g][5] += h * b.y; le[g][6] += h * b.z; le[g][7] += h * b.w; }
    }
#pragma unroll
    for (int g = 0; g < 4; ++g) { lg[g] = wave_sum(lg[g]) + b_rg[g];
#pragma unroll
        for (int e = 0; e < 8; ++e) le[g][e] = wave_sum(le[g][e]) + b_re[g * 8 + e]; }
    if (lane != 0) return;
    int gi = 0; float gm = lg[0];
#pragma unroll
    for (int g = 1; g < 4; ++g) if (lg[g] > gm) { gm = lg[g]; gi = g; }
    float den = 0.f;
#pragma unroll
    for (int g = 0; g < 4; ++g) den += __expf(lg[g] - gm);
    const float gw = 1.f / den;
    float v[8];
#pragma unroll
    for (int e = 0; e < 8; ++e) { v[e] = le[0][e];
#pragma unroll
        for (int g = 1; g < 4; ++g) v[e] = (gi == g) ? le[g][e] : v[e]; }
    int i1 = 0; float v1 = v[0];
#pragma unroll
    for (int e = 1; e < 8; ++e) if (v[e] > v1) { v1 = v[e]; i1 = e; }
    int i2 = -1; float v2 = -3.0e38f;
#pragma unroll
    for (int e = 0; e < 8; ++e) if (e != i1 && v[e] > v2) { v2 = v[e]; i2 = e; }
    const float ex = __expf(v2 - v1), w1 = gw / (1.f + ex), w2 = gw * ex / (1.f + ex);
    const unsigned e1 = gi * 8 + i1, e2 = gi * 8 + i2;
    const unsigned p1 = atomicAdd(&cnt[e1], 1u), p2 = atomicAdd(&cnt[e2], 1u);
    list[(size_t)e1 * M + p1] = t; listw[(size_t)e1 * M + p1] = w1; list[(size_t)e2 * M + p2] = t; listw[(size_t)e2 * M + p2] = w2;
    tokep[2 * t] = (e1 << 24) | p1; tokep[2 * t + 1] = (e2 << 24) | p2;
}
__global__ void k_bases(const unsigned* cnt, unsigned* base) {
    if (threadIdx.x == 0) { unsigned b = 0; for (int e = 0; e < NE; ++e) { base[e] = b; b += (cnt[e] + 255u) & ~255u; } base[NE] = b; }
}

__global__ void __launch_bounds__(256) k_moe_naive(const bf16_t* H1, const float* w_gate, const float* w_up, const float* w_down, const unsigned* tokep, const float* listw,
                                                   const unsigned* base, bf16_t* MOE) {
    __shared__ float hs[D]; __shared__ float as[DE];
    const int t = blockIdx.x, tid = threadIdx.x;
#pragma unroll
    for (int i = 0; i < 4; ++i) hs[tid + 256 * i] = bf2f(H1[(size_t)t * D + tid + 256 * i]);
    __syncthreads();
    for (int slot = 0; slot < 2; ++slot) {
        const unsigned ep = tokep[2 * t + slot], e = ep >> 24, pos = ep & 0xffffffu; const float w = listw[(size_t)e * M + pos];
        const float* wg = w_gate + (size_t)e * D * DE + tid; const float* wu = w_up + (size_t)e * D * DE + tid;
        float g = 0.f, u = 0.f;
        for (int k = 0; k < D; ++k) { g += hs[k] * wg[(size_t)k * DE]; u += hs[k] * wu[(size_t)k * DE]; }
        const float a = g / (1.f + __expf(-g)) * u * w;
        as[tid] = bf2f(f2bf(a));
        __syncthreads();
        const float* wd = w_down + (size_t)e * DE * D + tid * 4; float4 o = {0.f, 0.f, 0.f, 0.f};
        for (int f = 0; f < DE; ++f) { const float4 x = *(const float4*)(wd + (size_t)f * D); const float av = as[f]; o.x += av * x.x; o.y += av * x.y; o.z += av * x.z; o.w += av * x.w; }
        uint2 pk; pk.x = f2bf(o.x) | (f2bf(o.y) << 16); pk.y = f2bf(o.z) | (f2bf(o.w) << 16);
        *(uint2*)(MOE + (size_t)(base[e] + pos) * D + tid * 4) = pk;
        __syncthreads();
    }
}

extern "C" void kernel_launch(void* const* d_in, const int* in_sizes, int n_in, void* d_out, int out_size, void* d_ws, size_t ws_size, hipStream_t stream) {
    const float* x = (const float*)d_in[0]; const float* p = (const float*)d_in[1]; const float* ln_in_g = (const float*)d_in[2]; const float* ln_in_b = (const float*)d_in[3];
    const float* w_in = (const float*)d_in[4]; const float* conv_w = (const float*)d_in[5]; const float* conv_b = (const float*)d_in[6]; const float* pool_w = (const float*)d_in[7];
    const float* pool_scale = (const float*)d_in[8]; const float* w_out = (const float*)d_in[9]; const float* ln1_g = (const float*)d_in[10]; const float* ln1_b = (const float*)d_in[11];
    const float* w_rg = (const float*)d_in[12]; const float* b_rg = (const float*)d_in[13]; const float* w_re = (const float*)d_in[14]; const float* b_re = (const float*)d_in[15];
    const float* w_gate = (const float*)d_in[16]; const float* w_up = (const float*)d_in[17]; const float* w_down = (const float*)d_in[18]; const float* w_pg = (const float*)d_in[19];
    const float* b_pg = (const float*)d_in[20]; const float* w_ple = (const float*)d_in[21]; const float* ln2_g = (const float*)d_in[22]; const float* ln2_b = (const float*)d_in[23];
    unsigned char* ws = (unsigned char*)d_ws; float* out = (float*)d_out;
    unsigned* ctl = (unsigned*)(ws + WS_CTL); unsigned* cnt = ctl + CW_CNT; unsigned* base = ctl + CW_BASE;
    unsigned* list = (unsigned*)(ws + WS_LIST); float* listw = (float*)(ws + WS_LISTW); unsigned* tokep = (unsigned*)(ws + WS_TOKEP);
    float* W2F = (float*)(ws + WS_W2F); bf16_t* H0 = (bf16_t*)(ws + WS_H0); bf16_t* Y = (bf16_t*)(ws + WS_Y); bf16_t* H1 = (bf16_t*)(ws + WS_H1);
    bf16_t* PB = (bf16_t*)(ws + WS_PB); bf16_t* PP = (bf16_t*)(ws + WS_PP); bf16_t* MOE = (bf16_t*)(ws + WS_MOE);
    bf16_t* U2 = (bf16_t*)d_out;

    hipMemsetAsync(ws + WS_CTL, 0, 4096, stream);
    k_ln<true><<<M / 4, 256, 0, stream>>>(x, ln_in_g, ln_in_b, H0, M);
    k_cvt<<<M * PLE / 4 / 256, 256, 0, stream>>>(p, PB, M * PLE / 4);
    k_gemm_naive<EpiU2><<<dim3(INP / 4 / 16, M / 64), 256, 0, stream>>>(H0, D, w_in, INP, D, EpiU2{U2});
    k_stencil<<<M * 512 / 256, 256, 0, stream>>>(U2, conv_w, conv_b, Y);
    k_w2<<<D * D / 256, 256, 0, stream>>>(w_out, pool_w, pool_scale, W2F);
    k_gemm_naive<EpiR1><<<dim3(D / 4 / 16, M / 64), 256, 0, stream>>>(Y, D, W2F, D, D, EpiR1{H0, out});
    k_ln<true><<<M / 4, 256, 0, stream>>>(out, ln1_g, ln1_b, H1, M);
    k_router<<<M / 4, 256, 0, stream>>>(H1, w_rg, b_rg, w_re, b_re, cnt, list, listw, tokep);
    k_bases<<<1, 64, 0, stream>>>(cnt, base);
    k_moe_naive<<<M, 256, 0, stream>>>(H1, w_gate, w_up, w_down, tokep, listw, base, MOE);
    k_gemm_naive<EpiPP><<<dim3(D / 4 / 16, M / 64), 256, 0, stream>>>(PB, PLE, w_ple, D, PLE, EpiPP{PP});
    k_gemm_naive<EpiR2><<<dim3(D / 4 / 16, M / 64), 256, 0, stream>>>(H1, D, w_pg, D, D, EpiR2{H1, PP, MOE, tokep, base, b_pg, out});
    k_ln<false><<<M / 4, 256, 0, stream>>>(out, ln2_g, ln2_b, out, M);
}
```
